# Optimizing an MI355X kernel written in HIP

```python
import jax, jax.numpy as jnp
from jax import lax
import numpy as np

D_MODEL = 1024
BATCH = 2
SEQ = 8192
DEPTH = 1

RET_HEADS = 4
RET_DK = 128
RET_DV = 128
RET_WIDTH = RET_HEADS * RET_DV
RET_CHUNK = 128

ATT_HEADS = 8
ATT_KV_HEADS = 2
ATT_HEAD_DIM = 64
ATT_WIDTH = ATT_HEADS * ATT_HEAD_DIM
ATT_KV_WIDTH = ATT_KV_HEADS * ATT_HEAD_DIM
WINDOW = 128
ATT_BLOCK = 128

D_MIX = RET_WIDTH + ATT_WIDTH
SPLIT_SIZES = (RET_HEADS * RET_DK, RET_HEADS * RET_DK, RET_WIDTH, RET_WIDTH,
               ATT_WIDTH, ATT_KV_WIDTH, ATT_KV_WIDTH, ATT_WIDTH)
IN_COLS = sum(SPLIT_SIZES)
EPS = 1e-6
NEG_BIG = -1e30

kernel_name = "hymba_retention_swa_sink_sandwich"


def rms_norm(x, g):
    xf = x.astype(jnp.float32)
    y = xf * lax.rsqrt(jnp.mean(xf * xf, axis=-1, keepdims=True) + EPS)
    return (y * g.astype(jnp.float32)).astype(x.dtype)


def retention(q, k, v):
    bsz, seq, nh, dk = q.shape
    dv = v.shape[-1]
    c = RET_CHUNK
    nc = seq // c
    f32 = jnp.float32
    log_gamma = jnp.log1p(-jnp.exp2(-5.0 - jnp.arange(nh, dtype=f32)))
    pos = jnp.arange(c, dtype=f32)
    diff = pos[:, None] - pos[None, :]
    intra_decay = jnp.where(diff >= 0,
                            jnp.exp(log_gamma[:, None, None] * jnp.maximum(diff, 0.0)),
                            0.0)
    xi = jnp.exp(log_gamma[:, None] * (pos + 1.0))
    zeta = jnp.exp(log_gamma[:, None] * (c - 1.0 - pos))
    chunk_decay = jnp.exp(log_gamma * c)

    qc = q.astype(f32).reshape(bsz, nc, c, nh, dk)
    kc = k.astype(f32).reshape(bsz, nc, c, nh, dk) * (dk ** -0.5)
    vc = v.astype(f32).reshape(bsz, nc, c, nh, dv)

    scores = jnp.einsum('bnihd,bnjhd->bnhij', qc, kc) * intra_decay
    inner = jnp.einsum('bnhij,bnjhe->bnihe', scores, vc)
    kv = jnp.einsum('bnjhd,hj,bnjhe->bnhde', kc, zeta, vc)

    def step(state, kv_c):
        return chunk_decay[None, :, None, None] * state + kv_c, state

    _, prev = lax.scan(step, jnp.zeros((bsz, nh, dk, dv), f32), jnp.moveaxis(kv, 1, 0))
    prev = jnp.moveaxis(prev, 0, 1)
    cross = jnp.einsum('bnihd,hi,bnhde->bnihe', qc, xi, prev)
    o = (inner + cross).reshape(bsz, seq, nh, dv)
    mu = jnp.mean(o, axis=-1, keepdims=True)
    var = jnp.mean(jnp.square(o - mu), axis=-1, keepdims=True)
    o = (o - mu) * lax.rsqrt(var + EPS)
    return o.reshape(bsz, seq, nh * dv).astype(q.dtype)


def swa_sink_attention(q, k, v, sinks):
    bsz, seq, hq, d = q.shape
    hkv = k.shape[2]
    grp = hq // hkv
    t = ATT_BLOCK
    nb = seq // t
    f32 = jnp.float32
    qb = q.reshape(bsz, nb, t, hkv, grp, d)
    kb = k.reshape(bsz, nb, t, hkv, d)
    vb = v.reshape(bsz, nb, t, hkv, d)
    pad = ((0, 0), (1, 0), (0, 0), (0, 0), (0, 0))
    kk = jnp.concatenate([jnp.pad(kb, pad)[:, :-1], kb], axis=2)
    vv = jnp.concatenate([jnp.pad(vb, pad)[:, :-1], vb], axis=2)

    s = jnp.einsum('bnqhgd,bnkhd->bnhgqk', qb, kk).astype(f32) * (d ** -0.5)
    qpos = jnp.arange(t) + t
    kpos = jnp.arange(2 * t)
    dist = qpos[:, None] - kpos[None, :]
    blk = jnp.arange(nb)
    valid = ((dist >= 0) & (dist < WINDOW))[None] & \
        ((blk[:, None, None] > 0) | (kpos[None, None, :] >= t))
    slopes = jnp.exp2(-8.0 * (jnp.arange(hq, dtype=f32) + 1.0) / hq).reshape(hkv, grp)
    s = s - slopes[:, :, None, None] * dist.astype(f32)
    s = jnp.where(valid[None, :, None, None], s, NEG_BIG)
    sink = jnp.broadcast_to(sinks.astype(f32).reshape(1, 1, hkv, grp, 1, 1),
                            s.shape[:-1] + (1,))
    p = jax.nn.softmax(jnp.concatenate([s, sink], axis=-1), axis=-1)[..., :-1]
    o = jnp.einsum('bnhgqk,bnkhd->bnqhgd', p.astype(v.dtype), vv)
    return o.reshape(bsz, seq, hq * d)


def setup_inputs(seed: int = 0) -> dict:
    key = jax.random.key(seed)
    ks = jax.random.split(key, 7)
    x = jax.random.normal(ks[0], (BATCH, SEQ, D_MODEL), jnp.float32)
    g_pre = 1.0 + 0.02 * jax.random.normal(ks[1], (D_MODEL,), jnp.float32)
    w_in = jax.random.normal(ks[2], (D_MODEL, IN_COLS), jnp.float32) * D_MODEL ** -0.5
    sinks = 0.5 * jax.random.normal(ks[3], (ATT_HEADS,), jnp.float32)
    w_out = jax.random.normal(ks[4], (D_MIX, D_MODEL), jnp.float32) * D_MIX ** -0.5
    g_post = 1.0 + 0.02 * jax.random.normal(ks[5], (D_MODEL,), jnp.float32)
    return {"x": x, "g_pre": g_pre, "w_in": w_in, "sinks": sinks,
            "w_out": w_out, "g_post": g_post}


def reference(x, g_pre, w_in, sinks, w_out, g_post):
    bsz, seq, _ = x.shape
    for _layer in range(DEPTH):
        h = rms_norm(x, g_pre)
        proj = jnp.einsum('bsd,dc->bsc', h, w_in)
        bounds = list(np.cumsum(SPLIT_SIZES)[:-1])
        rq, rk, rv, rg, aq, ak, av, ag = jnp.split(proj, bounds, axis=-1)
        ret = retention(rq.reshape(bsz, seq, RET_HEADS, RET_DK),
                        rk.reshape(bsz, seq, RET_HEADS, RET_DK),
                        rv.reshape(bsz, seq, RET_HEADS, RET_DV))
        ret = ret * jax.nn.silu(rg)
        att = swa_sink_attention(aq.reshape(bsz, seq, ATT_HEADS, ATT_HEAD_DIM),
                                 ak.reshape(bsz, seq, ATT_KV_HEADS, ATT_HEAD_DIM),
                                 av.reshape(bsz, seq, ATT_KV_HEADS, ATT_HEAD_DIM),
                                 sinks)
        att = att * jax.nn.silu(ag)
        mixed = jnp.concatenate([ret, att], axis=-1)
        out = jnp.einsum('bsc,cd->bsd', mixed, w_out)
        x = x + rms_norm(out, g_post)
    return x
```

```cpp
#include <hip/hip_runtime.h>
#include <cstdint>
#include <cstdio>

constexpr int BATCH = 2, SEQ = 8192, D = 1024, M = BATCH * SEQ, NIN = 3328, DMIX = 1024;
constexpr int C_RQ = 0, C_RK = 512, C_RV = 1024, C_RG = 1536, C_AQ = 2048, C_AK = 2560, C_AV = 2688, C_AG = 2816;
constexpr int NCH = SEQ / 128;
constexpr float EPS = 1e-6f;

typedef unsigned short bf16_t;
__device__ __forceinline__ bf16_t f2bf(float f) { unsigned u = __builtin_bit_cast(unsigned, f); return (bf16_t)((u + 0x7fffu + ((u >> 16) & 1u)) >> 16); }
__device__ __forceinline__ float bf2f(bf16_t b) { return __builtin_bit_cast(float, (unsigned)b << 16); }

__device__ __forceinline__ float lg2gamma(int h) { return h == 0 ? -0.04580368961312479f : h == 1 ? -0.02272007650008353f : h == 2 ? -0.011315313227834146f : -0.005646563141142063f; }
__device__ __forceinline__ float chunk_decay(int h) { return h == 0 ? 0.017183023570817902f : h == 1 ? 0.1332151628796484f : h == 2 ? 0.3664377159220373f : 0.6059370882290803f; }
__device__ __forceinline__ float silu(float v) { return v / (1.0f + __expf(-v)); }

__device__ __forceinline__ float proj_epi(float v, int row, int col) {
    const int i = row & 127;
    if (col < C_RK) { return v * exp2f((float)(i + 1) * lg2gamma(col >> 7)); }
    if (col < C_RV) { return v * 0.08838834764831845f * exp2f(-(float)(i + 1) * lg2gamma((col - C_RK) >> 7)); }
    if (col < C_RG) return v;
    if (col < C_AQ) return silu(v);
    if (col < C_AK) return v * 0.125f;
    if (col < C_AG) return v;
    return silu(v);
}

__global__ void k_rstd(const float* __restrict__ x, float* __restrict__ rstd) {
    const int row = blockIdx.x * 4 + (threadIdx.x >> 6), lane = threadIdx.x & 63;
    const float4* xr = (const float4*)(x + (size_t)row * D);
    float s = 0.f;
    for (int j = 0; j < 4; ++j) { float4 v = xr[lane + 64 * j]; s += v.x * v.x + v.y * v.y + v.z * v.z + v.w * v.w; }
    for (int o = 1; o < 64; o <<= 1) s += __shfl_xor(s, o);
    if (lane == 0) rstd[row] = 1.0f / sqrtf(s * (1.0f / D) + EPS);
}

template <int MODE>
__global__ void __launch_bounds__(256) k_gemm(const void* __restrict__ Ap, const float* __restrict__ g, const float* __restrict__ rstd,
                                              const float* __restrict__ Bm, void* __restrict__ Cp, int N, int K) {
    __shared__ float As[16][68];
    __shared__ float Bs[16][68];
    const int tx = threadIdx.x & 15, ty = threadIdx.x >> 4;
    const int m0 = blockIdx.y * 64, n0 = blockIdx.x * 64;
    float acc[4][4] = {};
    for (int k0 = 0; k0 < K; k0 += 16) {
        {
            const int e = threadIdx.x * 4, r = e >> 4, c = e & 15;
            float a[4];
            if (MODE == 0) { const float* x = (const float*)Ap; const float4 v = *(const float4*)(x + (size_t)(m0 + r) * K + k0 + c); const float4 gg = *(const float4*)(g + k0 + c); const float rs = rstd[m0 + r];
                a[0] = v.x * gg.x * rs; a[1] = v.y * gg.y * rs; a[2] = v.z * gg.z * rs; a[3] = v.w * gg.w * rs; }
            else { const bf16_t* A = (const bf16_t*)Ap; const ushort4 v = *(const ushort4*)(A + (size_t)(m0 + r) * K + k0 + c); a[0] = bf2f(v.x); a[1] = bf2f(v.y); a[2] = bf2f(v.z); a[3] = bf2f(v.w); }
            for (int q = 0; q < 4; ++q) As[c + q][r] = a[q];
        }
        {
            const int e = threadIdx.x * 4, r = e >> 6, c = e & 63;
            const float4 v = *(const float4*)(Bm + (size_t)(k0 + r) * N + n0 + c);
            Bs[r][c] = v.x; Bs[r][c + 1] = v.y; Bs[r][c + 2] = v.z; Bs[r][c + 3] = v.w;
        }
        __syncthreads();
#pragma unroll
        for (int kk = 0; kk < 16; ++kk) {
            float a[4], b[4];
#pragma unroll
            for (int i = 0; i < 4; ++i) { a[i] = As[kk][ty * 4 + i]; b[i] = Bs[kk][tx * 4 + i]; }
#pragma unroll
            for (int i = 0; i < 4; ++i)
#pragma unroll
                for (int j = 0; j < 4; ++j) acc[i][j] += a[i] * b[j];
        }
        __syncthreads();
    }
    for (int i = 0; i < 4; ++i) {
        const int row = m0 + ty * 4 + i;
        for (int j = 0; j < 4; ++j) {
            const int col = n0 + tx * 4 + j;
            if (MODE == 0) ((bf16_t*)Cp)[(size_t)row * N + col] = f2bf(proj_epi(acc[i][j], row, col));
            else ((float*)Cp)[(size_t)row * N + col] = acc[i][j];
        }
    }
}

__global__ void k_ret_kv(const bf16_t* __restrict__ proj, float* __restrict__ skv) {
    const int unit = blockIdx.x, d = blockIdx.y, e = threadIdx.x;
    const int n = unit & 63, h = (unit >> 6) & 3, b = unit >> 8;
    const bf16_t* base = proj + (size_t)(b * SEQ + n * 128) * NIN;
    float acc = 0.f;
    for (int j = 0; j < 128; ++j) acc += bf2f(base[(size_t)j * NIN + C_RK + h * 128 + d]) * bf2f(base[(size_t)j * NIN + C_RV + h * 128 + e]);
    skv[((size_t)unit * 128 + d) * 128 + e] = acc;
}
__global__ void k_scan(const float* __restrict__ skv, bf16_t* __restrict__ prev) {
    const int idx = blockIdx.x * blockDim.x + threadIdx.x;
    const int bh = idx >> 14, de = idx & 16383, h = bh & 3;
    const float cd = chunk_decay(h);
    float st = 0.f;
    for (int n = 0; n < NCH; ++n) {
        const size_t o = ((size_t)(bh * 64 + n) << 14) + de;
        prev[o] = f2bf(st);
        st = cd * (st + skv[o]);
    }
}
__global__ void k_ret_out(const bf16_t* __restrict__ proj, const bf16_t* __restrict__ prev, bf16_t* __restrict__ mixed) {
    __shared__ float q[128], sc[128], red[4];
    const int unit = blockIdx.x, i = blockIdx.y, t = threadIdx.x;
    const int n = unit & 63, h = (unit >> 6) & 3, b = unit >> 8;
    const size_t row0 = (size_t)(b * SEQ + n * 128);
    const bf16_t* base = proj + row0 * NIN;
    q[t] = bf2f(base[(size_t)i * NIN + C_RQ + h * 128 + t]);
    __syncthreads();
    float s = 0.f;
    if (t <= i) { const bf16_t* kr = base + (size_t)t * NIN + C_RK + h * 128; for (int d = 0; d < 128; ++d) s += q[d] * bf2f(kr[d]); }
    sc[t] = s;
    __syncthreads();
    float o = 0.f;
    for (int j = 0; j <= i; ++j) o += sc[j] * bf2f(base[(size_t)j * NIN + C_RV + h * 128 + t]);
    const bf16_t* pv = prev + ((size_t)unit << 14);
    for (int d = 0; d < 128; ++d) o += q[d] * bf2f(pv[d * 128 + t]);
    float s1 = o;
    for (int off = 1; off < 64; off <<= 1) s1 += __shfl_xor(s1, off);
    if ((t & 63) == 0) red[t >> 6] = s1;
    __syncthreads();
    const float mu = (red[0] + red[1]) * (1.0f / 128.0f);
    const float dlt = o - mu;
    float s2 = dlt * dlt;
    for (int off = 1; off < 64; off <<= 1) s2 += __shfl_xor(s2, off);
    if ((t & 63) == 0) red[2 + (t >> 6)] = s2;
    __syncthreads();
    const float var = (red[2] + red[3]) * (1.0f / 128.0f);
    const float gate = bf2f(base[(size_t)i * NIN + C_RG + h * 128 + t]);
    mixed[(row0 + i) * DMIX + h * 128 + t] = f2bf(dlt * (1.0f / sqrtf(var + EPS)) * gate);
}
__global__ void k_attn(const bf16_t* __restrict__ proj, const float* __restrict__ sinks, bf16_t* __restrict__ mixed) {
    __shared__ float q[64], p[128], red[4];
    const int pos = blockIdx.x, hq = blockIdx.y, b = blockIdx.z, t = threadIdx.x;
    const int hkv = hq >> 2;
    const size_t row = (size_t)b * SEQ + pos;
    if (t < 64) q[t] = bf2f(proj[row * NIN + C_AQ + hq * 64 + t]);
    __syncthreads();
    const int kpos = pos - t;
    const float slope = exp2f(-(float)(hq + 1));
    const float NEG = -1e30f;
    float s = NEG;
    if (kpos >= 0) { const bf16_t* kr = proj + ((size_t)b * SEQ + kpos) * NIN + C_AK + hkv * 64; float a = 0.f; for (int d = 0; d < 64; ++d) a += q[d] * bf2f(kr[d]); s = a - slope * (float)t; }
    const float sink = sinks[hq];
    float mx = s;
    for (int off = 1; off < 64; off <<= 1) mx = fmaxf(mx, __shfl_xor(mx, off));
    if ((t & 63) == 0) red[t >> 6] = mx;
    __syncthreads();
    mx = fmaxf(fmaxf(red[0], red[1]), sink);
    const float e = (kpos >= 0) ? __expf(s - mx) : 0.f;
    float sum = e;
    for (int off = 1; off < 64; off <<= 1) sum += __shfl_xor(sum, off);
    if ((t & 63) == 0) red[2 + (t >> 6)] = sum;
    p[t] = e;
    __syncthreads();
    const float denom = red[2] + red[3] + __expf(sink - mx);
    if (t < 64) {
        float o = 0.f;
        const int kmax = pos < 127 ? pos : 127;
        for (int k = 0; k <= kmax; ++k) o += p[k] * bf2f(proj[((size_t)b * SEQ + pos - k) * NIN + C_AV + hkv * 64 + t]);
        const float gate = bf2f(proj[row * NIN + C_AG + hq * 64 + t]);
        mixed[row * DMIX + 512 + hq * 64 + t] = f2bf(o / denom * gate);
    }
}
__global__ void k_post(const float* __restrict__ x, const float* __restrict__ outf, const float* __restrict__ g, float* __restrict__ out) {
    const int row = blockIdx.x * 4 + (threadIdx.x >> 6), lane = threadIdx.x & 63;
    const float4* orow = (const float4*)(outf + (size_t)row * D);
    float4 v[4]; float s = 0.f;
    for (int j = 0; j < 4; ++j) { v[j] = orow[lane + 64 * j]; s += v[j].x * v[j].x + v[j].y * v[j].y + v[j].z * v[j].z + v[j].w * v[j].w; }
    for (int o = 1; o < 64; o <<= 1) s += __shfl_xor(s, o);
    const float rs = 1.0f / sqrtf(s * (1.0f / D) + EPS);
    const float4* xr = (const float4*)(x + (size_t)row * D); const float4* gr = (const float4*)g; float4* o4 = (float4*)(out + (size_t)row * D);
    for (int j = 0; j < 4; ++j) { const float4 xx = xr[lane + 64 * j], gg = gr[lane + 64 * j]; float4 r;
        r.x = xx.x + v[j].x * rs * gg.x; r.y = xx.y + v[j].y * rs * gg.y; r.z = xx.z + v[j].z * rs * gg.z; r.w = xx.w + v[j].w * rs * gg.w; o4[lane + 64 * j] = r; }
}

constexpr size_t MiB = 1u << 20;
constexpr size_t WS_RSTD = 0;
constexpr size_t WS_PROJ = 1 * MiB;
constexpr size_t WS_SKV = 105 * MiB;
constexpr size_t WS_PREV = 137 * MiB;
constexpr size_t WS_MIXED = 153 * MiB;
constexpr size_t WS_OUTF = 185 * MiB;
constexpr size_t WS_END = 249 * MiB;

extern "C" void kernel_launch(void* const* d_in, const int* in_sizes, int n_in, void* d_out, int out_size, void* d_ws, size_t ws_size, hipStream_t stream) {
    if (n_in != 6 || in_sizes[0] != M * D || out_size != M * D || ws_size < WS_END) { fprintf(stderr, "kernel_launch: unexpected shapes (n_in %d in0 %d out %d ws %zu)\n", n_in, n_in > 0 ? in_sizes[0] : -1, out_size, ws_size); return; }
    const float* x = (const float*)d_in[0]; const float* g_pre = (const float*)d_in[1]; const float* w_in = (const float*)d_in[2];
    const float* sinks = (const float*)d_in[3]; const float* w_out = (const float*)d_in[4]; const float* g_post = (const float*)d_in[5];
    unsigned char* ws = (unsigned char*)d_ws;
    float* rstd = (float*)(ws + WS_RSTD); bf16_t* proj = (bf16_t*)(ws + WS_PROJ); float* skv = (float*)(ws + WS_SKV); bf16_t* prev = (bf16_t*)(ws + WS_PREV);
    bf16_t* mixed = (bf16_t*)(ws + WS_MIXED); float* outf = (float*)(ws + WS_OUTF);
    k_rstd<<<M / 4, 256, 0, stream>>>(x, rstd);
    k_gemm<0><<<dim3(NIN / 64, M / 64), 256, 0, stream>>>(x, g_pre, rstd, w_in, proj, NIN, D);
    k_ret_kv<<<dim3(512, 128), 128, 0, stream>>>(proj, skv);
    k_scan<<<(8 * 16384) / 256, 256, 0, stream>>>(skv, prev);
    k_ret_out<<<dim3(512, 128), 128, 0, stream>>>(proj, prev, mixed);
    k_attn<<<dim3(SEQ, 8, BATCH), 128, 0, stream>>>(proj, sinks, mixed);
    k_gemm<1><<<dim3(D / 64, M / 64), 256, 0, stream>>>(mixed, nullptr, nullptr, w_out, outf, D, DMIX);
    k_post<<<M / 4, 256, 0, stream>>>(x, outf, g_post, (float*)d_out);
}
```
